# Optimizing an MI355X kernel written in HIP

```python
import jax, jax.numpy as jnp
from jax import lax
import numpy as np

D_MODEL = 1024
BATCH = 16
SEQ = 2048
DEPTH = 1

CHUNK = 64
RWKV_WIDTH = 512
HEAD_SIZE = 64
N_HEADS = RWKV_WIDTH // HEAD_SIZE
DECAY_LORA = 64
AAA_LORA = 64
GATE_LORA = 128
GN_EPS = HEAD_SIZE * 1e-5
POOL_WIDTH = 512
POOL_WINDOWS = (2, 4, 8, 16)
N_POOL_GROUPS = len(POOL_WINDOWS)
POOL_GROUP = POOL_WIDTH // N_POOL_GROUPS
N_BRANCH = 2
PROJ_WIDTH = 3 * RWKV_WIDTH + POOL_WIDTH + N_BRANCH * D_MODEL
D_FF = 2816
RMS_EPS = 1e-6

kernel_name = "macaron_gated_rwkv7_multiscale_pool_block"


def rms_norm(x, g):
    xf = x.astype(jnp.float32)
    y = xf * lax.rsqrt(jnp.mean(xf * xf, axis=-1, keepdims=True) + RMS_EPS)
    return (y * g.astype(jnp.float32)).astype(x.dtype)


def token_shift(x):
    return jnp.pad(x, ((0, 0), (1, 0), (0, 0)))[:, :-1]


def swiglu(x, w_gate, w_up, w_down):
    return (jax.nn.silu(x @ w_gate) * (x @ w_up)) @ w_down


def wkv7_recurrence(r, decay, k, v, a_vec, b_vec):
    b, s, h, n = r.shape

    def to_chunks(t):
        return t.astype(jnp.float32).transpose(1, 0, 2, 3).reshape(s // CHUNK, CHUNK, b, h, n)

    def frame_step(state, inp):
        r_t, w_t, k_t, v_t, a_t, b_t = inp
        sa = jnp.einsum('bhij,bhj->bhi', state, a_t)
        state = (state * w_t[:, :, None, :]
                 + sa[..., None] * b_t[:, :, None, :]
                 + v_t[..., None] * k_t[:, :, None, :])
        y_t = jnp.einsum('bhij,bhj->bhi', state, r_t)
        return state, y_t

    def chunk_step(state, chunk_inp):
        return lax.scan(frame_step, state, chunk_inp)

    state0 = jnp.zeros((b, h, n, n), jnp.float32)
    inputs = (to_chunks(r), to_chunks(decay), to_chunks(k), to_chunks(v),
              to_chunks(a_vec), to_chunks(b_vec))
    _, y = lax.scan(chunk_step, state0, inputs)
    return y.reshape(s, b, h, n).transpose(1, 0, 2, 3)


def rwkv7_branch(h, p_r, p_k, p_v, mu_rkv, mu_wag, w0, decay_a, decay_b, a0,
                 aaa_a, aaa_b, gate_a, gate_b, k_k, k_a, r_k, ln_x_w, ln_x_b):
    bsz, s, _ = h.shape
    f32 = jnp.float32
    r = p_r + (token_shift(p_r) - p_r) * mu_rkv[0]
    k = p_k + (token_shift(p_k) - p_k) * mu_rkv[1]
    v = p_v + (token_shift(p_v) - p_v) * mu_rkv[2]
    hx = token_shift(h) - h
    xw = h + hx * mu_wag[0]
    xa = h + hx * mu_wag[1]
    xg = h + hx * mu_wag[2]
    w_log = -jax.nn.softplus(-(w0 + jnp.tanh(xw @ decay_a) @ decay_b).astype(f32)) - 0.5
    decay = jnp.exp(-jnp.exp(w_log))
    a = jax.nn.sigmoid((a0 + (xa @ aaa_a) @ aaa_b).astype(f32))
    g = jax.nn.sigmoid(xg @ gate_a) @ gate_b

    heads = lambda t: t.reshape(bsz, s, N_HEADS, HEAD_SIZE)
    pheads = lambda t: t.astype(f32).reshape(N_HEADS, HEAD_SIZE)
    r_h, k_h, v_h = heads(r.astype(f32)), heads(k.astype(f32)), heads(v.astype(f32))
    a_h, w_h = heads(a), heads(decay)
    kk = k_h * pheads(k_k)
    kk = kk / jnp.maximum(jnp.sqrt(jnp.sum(kk * kk, axis=-1, keepdims=True)), 1e-12)
    k_h = k_h * (1.0 + (a_h - 1.0) * pheads(k_a))

    y = wkv7_recurrence(r_h, w_h, k_h, v_h, -kk, kk * a_h)
    mu = jnp.mean(y, axis=-1, keepdims=True)
    var = jnp.mean(jnp.square(y - mu), axis=-1, keepdims=True)
    y = (y - mu) * lax.rsqrt(var + GN_EPS)
    y = y * pheads(ln_x_w) + pheads(ln_x_b)
    bonus = jnp.sum(r_h * k_h * r_k.astype(f32), axis=-1, keepdims=True) * v_h
    y = (y + bonus).reshape(bsz, s, RWKV_WIDTH)
    return (y * g.astype(f32)).astype(h.dtype)


def multiscale_pool_branch(p, pool_w, pool_scale):
    bsz, s, _ = p.shape
    pf = p.astype(jnp.float32).reshape(bsz, s, N_POOL_GROUPS, POOL_GROUP)
    cs = jnp.pad(jnp.cumsum(pf, axis=1), ((0, 0), (1, 0), (0, 0), (0, 0)))
    windows = jnp.array(POOL_WINDOWS, dtype=jnp.int32)
    hi = jnp.arange(1, s + 1, dtype=jnp.int32)[:, None]
    lo = jnp.maximum(hi - windows[None, :], 0)
    cs_lo = cs[:, lo, jnp.arange(N_POOL_GROUPS)[None, :], :]
    count = (hi - lo).astype(jnp.float32)[None, :, :, None]
    mixed = (cs[:, 1:] - cs_lo) / count - pf
    out = jnp.einsum('bsgc,gcd->bsgd', mixed, pool_w.astype(jnp.float32))
    out = out.reshape(bsz, s, POOL_WIDTH) * pool_scale.astype(jnp.float32)
    return out.astype(p.dtype)


def _normal(key, shape, fan_in, scale=1.0):
    return scale * jax.random.normal(key, shape, jnp.float32) * (fan_in ** -0.5)


def setup_inputs(seed: int = 0) -> dict:
    key = jax.random.key(seed)
    ks = jax.random.split(key, 40)
    L, D, RW, PW = DEPTH, D_MODEL, RWKV_WIDTH, POOL_WIDTH
    nrm = lambda k, shape: jax.random.normal(k, shape, jnp.float32)
    return {
        "x": nrm(ks[0], (BATCH, SEQ, D)),
        "norm_gains": 1.0 + 0.02 * nrm(ks[1], (L, 6, D)),
        "ffn1_gate": _normal(ks[2], (L, D, D_FF), D),
        "ffn1_up": _normal(ks[3], (L, D, D_FF), D),
        "ffn1_down": _normal(ks[4], (L, D_FF, D), D_FF),
        "w_in": _normal(ks[5], (L, D, PROJ_WIDTH), D),
        "gate_bias": 0.1 * nrm(ks[6], (L, N_BRANCH, D)),
        "mu_rkv": jax.random.uniform(ks[7], (L, 3, RW), jnp.float32),
        "mu_wag": jax.random.uniform(ks[8], (L, 3, D), jnp.float32),
        "w0": jax.random.uniform(ks[9], (L, RW), jnp.float32, minval=-6.5, maxval=-1.5),
        "decay_a": _normal(ks[10], (L, D, DECAY_LORA), D),
        "decay_b": _normal(ks[11], (L, DECAY_LORA, RW), DECAY_LORA, 0.1),
        "a0": 0.1 * nrm(ks[12], (L, RW)),
        "aaa_a": _normal(ks[13], (L, D, AAA_LORA), D),
        "aaa_b": _normal(ks[14], (L, AAA_LORA, RW), AAA_LORA),
        "gate_a": _normal(ks[15], (L, D, GATE_LORA), D),
        "gate_b": _normal(ks[16], (L, GATE_LORA, RW), GATE_LORA),
        "k_k": 0.85 + 0.02 * nrm(ks[17], (L, RW)),
        "k_a": 1.0 + 0.02 * nrm(ks[18], (L, RW)),
        "r_k": 0.1 * nrm(ks[19], (L, N_HEADS, HEAD_SIZE)),
        "ln_x_w": 1.0 + 0.02 * nrm(ks[20], (L, RW)),
        "ln_x_b": 0.02 * nrm(ks[21], (L, RW)),
        "pool_w": _normal(ks[22], (L, N_POOL_GROUPS, POOL_GROUP, POOL_GROUP), POOL_GROUP),
        "pool_scale": 1.0 + 0.02 * nrm(ks[23], (L, PW)),
        "w_branch_rwkv": _normal(ks[24], (L, RW, D), RW),
        "w_branch_pool": _normal(ks[25], (L, PW, D), PW),
        "w_out": _normal(ks[26], (L, D, D), D),
        "ffn2_gate": _normal(ks[27], (L, D, D_FF), D),
        "ffn2_up": _normal(ks[28], (L, D, D_FF), D),
        "ffn2_down": _normal(ks[29], (L, D_FF, D), D_FF),
    }


def reference(x, norm_gains, ffn1_gate, ffn1_up, ffn1_down, w_in, gate_bias, mu_rkv,
              mu_wag, w0, decay_a, decay_b, a0, aaa_a, aaa_b, gate_a, gate_b, k_k, k_a,
              r_k, ln_x_w, ln_x_b, pool_w, pool_scale, w_branch_rwkv, w_branch_pool,
              w_out, ffn2_gate, ffn2_up, ffn2_down):
    bsz, s, d = x.shape
    split_at = [RWKV_WIDTH, 2 * RWKV_WIDTH, 3 * RWKV_WIDTH, 3 * RWKV_WIDTH + POOL_WIDTH]
    for l in range(DEPTH):
        g = norm_gains[l]
        f = swiglu(rms_norm(x, g[0]), ffn1_gate[l], ffn1_up[l], ffn1_down[l])
        x = x + 0.5 * rms_norm(f, g[1])

        h = rms_norm(x, g[2])
        proj = h @ w_in[l]
        p_r, p_k, p_v, p_pool, gate_logits = jnp.split(proj, split_at, axis=-1)
        gates = jax.nn.sigmoid(gate_logits.reshape(bsz, s, N_BRANCH, d) + gate_bias[l])

        y_rwkv = rwkv7_branch(h, p_r, p_k, p_v, mu_rkv[l], mu_wag[l], w0[l], decay_a[l],
                              decay_b[l], a0[l], aaa_a[l], aaa_b[l], gate_a[l], gate_b[l],
                              k_k[l], k_a[l], r_k[l], ln_x_w[l], ln_x_b[l])
        y_pool = multiscale_pool_branch(p_pool, pool_w[l], pool_scale[l])

        merged = (gates[:, :, 0] * (y_rwkv @ w_branch_rwkv[l])
                  + gates[:, :, 1] * (y_pool @ w_branch_pool[l]))
        x = x + rms_norm(merged @ w_out[l], g[3])

        f = swiglu(rms_norm(x, g[4]), ffn2_gate[l], ffn2_up[l], ffn2_down[l])
        x = x + 0.5 * rms_norm(f, g[5])
    return x
```

```cpp
#include <hip/hip_runtime.h>
#include <cstdio>
#include <cstdint>

#ifndef MK_N_LAUNCHES
#define MK_N_LAUNCHES 13
#endif

namespace pg8 {
#define PG8_LAS __attribute__((address_space(3)))
typedef unsigned short bf16_t;
typedef short bf16x8 __attribute__((ext_vector_type(8)));
typedef float f32x4 __attribute__((ext_vector_type(4)));
typedef float f32x2 __attribute__((ext_vector_type(2)));
typedef unsigned u32x4 __attribute__((ext_vector_type(4)));
typedef unsigned u32x2 __attribute__((ext_vector_type(2)));
constexpr int BM = 256, BK = 64, HALF = 128, HTB = HALF * BK * 2, STAGE_BYTES = 8 * HTB, NXCD = 8, WGM = 8;

__host__ __device__ __forceinline__ int lds_byte(int r, int c) { const int st = (r >> 4) * 2 + (c >> 5), rr = r & 15, cc = c & 31, ob = rr * 64 + cc * 2; return st * 1024 + (ob ^ (((ob >> 9) & 1) << 5)); }
__host__ __device__ __forceinline__ void stage_rc(int b, int& R, int& C) { const int st = b / 1024, sb = b % 1024, swz = sb ^ (((sb >> 9) & 1) << 5); R = (st >> 1) * 16 + swz / 64; C = (st & 1) * 32 + (swz % 64) / 2; }
__host__ __device__ __forceinline__ int perm32(int rho) { const int n = rho >> 4, i = rho & 15; return 8 * (i >> 2) + 4 * n + (i & 3); }

struct Unit { int pm, pn; };
struct Gemm { const bf16_t* A; const bf16_t* Bt; };

struct StaticOrder {
    int nM, nN, nwg, G, c;
    __host__ __device__ void init(int M, int N, int G_, int c_) { nM = M / BM; nN = N / BM; nwg = nM * nN; G = G_; c = c_; }
    __host__ __device__ bool next(int i, Unit& u) const {
        const long L = (long)i * G + c; if (L >= nwg) return false;
        int wgid = (int)L; { const int q = nwg / NXCD, r = nwg % NXCD, xcd = wgid % NXCD, off = wgid / NXCD; wgid = (xcd < r ? xcd * (q + 1) : r * (q + 1) + (xcd - r) * q) + off; }
        const int nig = WGM * nN, gid = wgid / nig, fm = gid * WGM, gsz = (nM - fm) < WGM ? (nM - fm) : WGM;
        u.pm = fm + ((wgid % nig) % gsz); u.pn = (wgid % nig) / gsz; return true;
    }
};

__device__ __forceinline__ unsigned cvt_pk_bf16(float lo, float hi) { unsigned r; asm volatile("v_cvt_pk_bf16_f32 %0, %1, %2" : "=v"(r) : "v"(lo), "v"(hi)); return r; }
__device__ __forceinline__ float bf_lo(unsigned w) { return __builtin_bit_cast(float, w << 16); }
__device__ __forceinline__ float bf_hi(unsigned w) { return __builtin_bit_cast(float, w & 0xffff0000u); }

template <class Epi, bool ALIGN_EPI, bool SP2, int KSPLIT, int K, int LDA, int LDB, int APNOFF>
__device__ __forceinline__ void gemm_phase(PG8_LAS unsigned char* lds, const Gemm g, const StaticOrder& S, const Epi& E) {
    const int tid = threadIdx.x, wid = __builtin_amdgcn_readfirstlane(tid >> 6), lane = tid & 63, wr = wid >> 2, wc = wid & 3, fr = lane & 15, fq = lane >> 4;
    constexpr int nt = K / BK;
    unsigned voffA[2], voffB[2];
#pragma unroll
    for (int i = 0; i < 2; ++i) { int R, C; stage_rc(tid * 16 + i * 8192, R, C); const int Rb = (R & ~31) + perm32(R & 31);
        voffA[i] = (unsigned)(R * LDA + C) * 2u; voffB[i] = (unsigned)(Rb * LDB + C) * 2u; }
    constexpr size_t kstep = (size_t)(BK * 2);
    constexpr size_t hstepA = (size_t)HALF * LDA * 2, hstepB = (size_t)HALF * LDB * 2;
    constexpr size_t tstepA = 2 * hstepA, tstepB = 2 * hstepB;
    const unsigned ldsw = (unsigned)wid * 1024u;
    const int aoff = lds_byte(wr * 64 + fr, fq * 8), boff = lds_byte(wc * 32 + fr, fq * 8);
#define PG8_SA(b, h) (((b) * 2 + (h)) * HTB)
#define PG8_SB(b, h) ((4 + (b) * 2 + (h)) * HTB)
#define PG8_STAGE(bufoff, gbase, voff) do { _Pragma("unroll") for (int _i = 0; _i < 2; ++_i) \
        __builtin_amdgcn_global_load_lds((const unsigned*)((const char*)(gbase) + (voff)[_i]), (PG8_LAS unsigned*)(lds + (bufoff) + ldsw + _i * 8192), 16, 0, 0); } while (0)
#define PG8_LDA(dst, b, h) do { _Pragma("unroll") for (int m = 0; m < 4; ++m) _Pragma("unroll") for (int k = 0; k < 2; ++k) dst[m][k] = *(const PG8_LAS bf16x8*)(lds + PG8_SA(b, h) + aoff + m * 2048 + k * 1024); } while (0)
#define PG8_LDB(dst, b, h) do { _Pragma("unroll") for (int n = 0; n < 2; ++n) _Pragma("unroll") for (int k = 0; k < 2; ++k) dst[n][k] = *(const PG8_LAS bf16x8*)(lds + PG8_SB(b, h) + boff + n * 2048 + k * 1024); } while (0)
#define PG8_MMA(ai, bj, At, Bt) do { __builtin_amdgcn_s_setprio(1); _Pragma("unroll") for (int m = 0; m < 4; ++m) _Pragma("unroll") for (int n = 0; n < 2; ++n) _Pragma("unroll") for (int k = 0; k < 2; ++k) \
        acc[ai][bj][m][n] = __builtin_amdgcn_mfma_f32_16x16x32_bf16(Bt[n][k], At[m][k], acc[ai][bj][m][n], 0, 0, 0); __builtin_amdgcn_s_setprio(0); } while (0)
#define PG8_WAIT_V(n) asm volatile("s_waitcnt vmcnt(" #n ")" ::: "memory")
#define PG8_WAIT_L(n) asm volatile("s_waitcnt lgkmcnt(" #n ")" ::: "memory")
#define PG8_BAR __builtin_amdgcn_s_barrier()
#define PG8_SCHED __builtin_amdgcn_sched_barrier(0)
    Unit cur, nxt; int ui = 0; int part = 0, npart = 0;
    if (!S.next(0, cur)) return;
    f32x4 acc[2][2][4][2];
#pragma unroll
    for (int a = 0; a < 2; ++a)
#pragma unroll
        for (int b = 0; b < 2; ++b)
#pragma unroll
            for (int m = 0; m < 4; ++m)
#pragma unroll
                for (int n = 0; n < 2; ++n) acc[a][b][m][n] = (f32x4){0.f, 0.f, 0.f, 0.f};
    bf16x8 At[4][2], B0[2][2], B1[2][2];
    constexpr size_t pstep = (size_t)K * 2;
    const char* cA = (const char*)g.A + (size_t)cur.pm * tstepA + (size_t)cur.pn * (APNOFF * 2); const char* cB = (const char*)g.Bt + (size_t)cur.pn * tstepB;
    if constexpr (SP2) {
        PG8_STAGE(PG8_SB(0, 0), cB, voffB); PG8_STAGE(PG8_SB(0, 1), cB + hstepB, voffB); PG8_STAGE(PG8_SA(0, 0), cA, voffA); PG8_STAGE(PG8_SA(0, 1), cA + hstepA, voffA);
        if (wr == 1) PG8_BAR;
        PG8_WAIT_V(2); PG8_BAR;
        PG8_STAGE(PG8_SB(1, 0), cB + kstep, voffB); PG8_STAGE(PG8_SA(1, 0), cA + kstep, voffA); PG8_STAGE(PG8_SB(1, 1), cB + hstepB + kstep, voffB);
        PG8_WAIT_V(6); PG8_BAR;
    } else {
        PG8_STAGE(PG8_SB(0, 0), cB, voffB); PG8_STAGE(PG8_SA(0, 0), cA, voffA); PG8_STAGE(PG8_SB(0, 1), cB + hstepB, voffB); PG8_STAGE(PG8_SA(0, 1), cA + hstepA, voffA);
        if (wr == 1) PG8_BAR;
        PG8_WAIT_V(4); PG8_BAR;
        PG8_STAGE(PG8_SB(1, 0), cB + kstep, voffB); PG8_STAGE(PG8_SA(1, 0), cA + kstep, voffA); PG8_STAGE(PG8_SB(1, 1), cB + hstepB + kstep, voffB);
        PG8_WAIT_V(6); PG8_BAR;
    }
    for (;;) {
        npart = (KSPLIT == 1) ? 0 : (ui + 1) % KSPLIT;
        const bool has_next = S.next((KSPLIT == 1) ? ui + 1 : (ui + 1) / KSPLIT, nxt);
        const char* nA = has_next ? (const char*)g.A + (size_t)nxt.pm * tstepA + (size_t)nxt.pn * (APNOFF * 2) + (size_t)npart * pstep : cA; const char* nB = has_next ? (const char*)g.Bt + (size_t)nxt.pn * tstepB + (size_t)npart * pstep : cB;
#pragma clang loop unroll(disable)
        for (int t = 0; t < nt; t += 2) {
            const bool last = (t == nt - 2);
            const char* a1 = cA + (size_t)(t + 1) * kstep;
            const char* a2 = last ? nA : cA + (size_t)(t + 2) * kstep; const char* b2 = last ? nB : cB + (size_t)(t + 2) * kstep;
            const char* a3 = a2 + kstep; const char* b3 = b2 + kstep;
            if constexpr (SP2) {
            PG8_LDB(B0, 0, 0); PG8_LDB(B1, 0, 1); PG8_SCHED; PG8_LDA(At, 0, 0); PG8_STAGE(PG8_SA(1, 1), a1 + hstepA, voffA);
            PG8_WAIT_V(8); PG8_WAIT_L(0); PG8_BAR; PG8_MMA(0, 0, At, B0); PG8_MMA(0, 1, At, B1); PG8_BAR; PG8_SCHED;
            PG8_LDA(At, 0, 1); PG8_STAGE(PG8_SB(0, 0), b2, voffB); PG8_STAGE(PG8_SB(0, 1), b2 + hstepB, voffB); PG8_STAGE(PG8_SA(0, 0), a2, voffA);
            PG8_WAIT_V(8); PG8_WAIT_L(0); PG8_BAR; PG8_MMA(1, 0, At, B0); PG8_MMA(1, 1, At, B1); PG8_BAR; PG8_SCHED;
            PG8_LDB(B0, 1, 0); PG8_LDB(B1, 1, 1); PG8_SCHED; PG8_LDA(At, 1, 0); PG8_STAGE(PG8_SA(0, 1), a2 + hstepA, voffA);
            PG8_WAIT_V(8); PG8_WAIT_L(0); PG8_BAR; PG8_MMA(0, 0, At, B0); PG8_MMA(0, 1, At, B1); PG8_BAR; PG8_SCHED;
            PG8_LDA(At, 1, 1); PG8_STAGE(PG8_SB(1, 0), b3, voffB); PG8_STAGE(PG8_SB(1, 1), b3 + hstepB, voffB); PG8_STAGE(PG8_SA(1, 0), a3, voffA);
            PG8_WAIT_V(8); PG8_WAIT_L(0); PG8_BAR; PG8_MMA(1, 0, At, B0); PG8_MMA(1, 1, At, B1); PG8_BAR; PG8_SCHED;
            } else {
            PG8_LDB(B0, 0, 0); PG8_SCHED; PG8_LDA(At, 0, 0); PG8_STAGE(PG8_SA(1, 1), a1 + hstepA, voffA);
            PG8_WAIT_L(8); PG8_BAR; PG8_WAIT_L(0); PG8_MMA(0, 0, At, B0); PG8_BAR; PG8_SCHED;
            PG8_LDB(B1, 0, 1); PG8_STAGE(PG8_SB(0, 0), b2, voffB);
            PG8_BAR; PG8_WAIT_L(0); PG8_MMA(0, 1, At, B1); PG8_BAR;
            PG8_LDA(At, 0, 1); PG8_STAGE(PG8_SA(0, 0), a2, voffA);
            PG8_BAR; PG8_WAIT_L(0); PG8_MMA(1, 0, At, B0); PG8_BAR; PG8_SCHED;
            PG8_STAGE(PG8_SB(0, 1), b2 + hstepB, voffB);
            PG8_WAIT_V(6); PG8_BAR; PG8_MMA(1, 1, At, B1); PG8_BAR;
            PG8_LDB(B0, 1, 0); PG8_SCHED; PG8_LDA(At, 1, 0); PG8_STAGE(PG8_SA(0, 1), a2 + hstepA, voffA);
            PG8_WAIT_L(8); PG8_BAR; PG8_WAIT_L(0); PG8_MMA(0, 0, At, B0); PG8_BAR; PG8_SCHED;
            PG8_LDB(B1, 1, 1); PG8_STAGE(PG8_SB(1, 0), b3, voffB);
            PG8_BAR; PG8_WAIT_L(0); PG8_MMA(0, 1, At, B1); PG8_BAR;
            PG8_LDA(At, 1, 1); PG8_STAGE(PG8_SA(1, 0), a3, voffA);
            PG8_BAR; PG8_WAIT_L(0); PG8_MMA(1, 0, At, B0); PG8_BAR; PG8_SCHED;
            PG8_STAGE(PG8_SB(1, 1), b3 + hstepB, voffB);
            PG8_WAIT_V(6); PG8_BAR; PG8_MMA(1, 1, At, B1); PG8_BAR;
            }
        }
        if constexpr (ALIGN_EPI) { if (wr == 0) PG8_BAR; }
        if constexpr (KSPLIT > 1) { if (part < KSPLIT - 1) E.mid(acc, cur, wr, wc, fr, fq); else E(acc, cur, wr, wc, fr, fq); }
        else E(acc, cur, wr, wc, fr, fq);
        if (!has_next) break;
        if (KSPLIT == 1 || part == KSPLIT - 1) {
#pragma unroll
        for (int a = 0; a < 2; ++a)
#pragma unroll
            for (int b = 0; b < 2; ++b)
#pragma unroll
                for (int m = 0; m < 4; ++m)
#pragma unroll
                    for (int n = 0; n < 2; ++n) acc[a][b][m][n] = (f32x4){0.f, 0.f, 0.f, 0.f};
        }
        cur = nxt; cA = nA; cB = nB; ++ui; part = npart;
        if constexpr (ALIGN_EPI) { if (wr == 1) PG8_BAR; }
    }
    PG8_WAIT_V(0);
    if constexpr (!ALIGN_EPI) { if (wr == 0) PG8_BAR; }
    PG8_BAR;
#undef PG8_SA
#undef PG8_SB
#undef PG8_STAGE
#undef PG8_LDA
#undef PG8_LDB
#undef PG8_MMA
#undef PG8_WAIT_V
#undef PG8_WAIT_L
#undef PG8_BAR
#undef PG8_SCHED
}

__device__ __forceinline__ float sigmoidf_(float x) { return 1.0f / (1.0f + __expf(-x)); }

struct EpiSwiGLU {
    bf16_t* O; int ldc;
    __device__ __forceinline__ void operator()(const f32x4 (&acc)[2][2][4][2], const Unit& u, int wr, int wc, int fr, int fq) const {
        const int row0 = u.pm * BM + wr * 64 + fr, col0 = u.pn * HALF + wc * 32 + 8 * fq;
#pragma unroll
        for (int ai = 0; ai < 2; ++ai)
#pragma unroll
            for (int m = 0; m < 4; ++m) { bf16_t* rowp = O + (size_t)(row0 + ai * HALF + m * 16) * ldc + col0;
                float o[8];
#pragma unroll
                for (int n = 0; n < 2; ++n)
#pragma unroll
                    for (int j = 0; j < 4; ++j) { const float gt = acc[ai][0][m][n][j], up = acc[ai][1][m][n][j]; o[n * 4 + j] = gt * __builtin_amdgcn_rcpf(1.0f + __expf(-gt)) * up; }
                u32x4 w; w.x = cvt_pk_bf16(o[0], o[1]); w.y = cvt_pk_bf16(o[2], o[3]); w.z = cvt_pk_bf16(o[4], o[5]); w.w = cvt_pk_bf16(o[6], o[7]);
                *(u32x4*)rowp = w; }
    }
};
struct EpiF32 {
    float* C; int ldc;
    __device__ __forceinline__ void operator()(const f32x4 (&acc)[2][2][4][2], const Unit& u, int wr, int wc, int fr, int fq) const {
        const int row0 = u.pm * BM + wr * 64 + fr, col0 = u.pn * BM + wc * 32 + 8 * fq;
#pragma unroll
        for (int ai = 0; ai < 2; ++ai)
#pragma unroll
            for (int m = 0; m < 4; ++m) { float* rowp = C + (size_t)(row0 + ai * HALF + m * 16) * ldc + col0;
#pragma unroll
                for (int bj = 0; bj < 2; ++bj) { *(f32x4*)(rowp + bj * HALF) = acc[ai][bj][m][0]; *(f32x4*)(rowp + bj * HALF + 4) = acc[ai][bj][m][1]; } }
    }
};
struct EpiBf16S {
    bf16_t* O; int ldc; int coff; const float* scale;
    __device__ __forceinline__ void operator()(const f32x4 (&acc)[2][2][4][2], const Unit& u, int wr, int wc, int fr, int fq) const {
        const int row0 = u.pm * BM + wr * 64 + fr, col0 = u.pn * BM + wc * 32 + 8 * fq;
#pragma unroll
        for (int bj = 0; bj < 2; ++bj) {
            f32x4 s0 = (f32x4){1.f, 1.f, 1.f, 1.f}, s1 = s0;
            if (scale) { s0 = *(const f32x4*)(scale + col0 + bj * HALF); s1 = *(const f32x4*)(scale + col0 + bj * HALF + 4); }
#pragma unroll
            for (int ai = 0; ai < 2; ++ai)
#pragma unroll
                for (int m = 0; m < 4; ++m) { bf16_t* rowp = O + (size_t)(row0 + ai * HALF + m * 16) * ldc + coff + col0 + bj * HALF;
                    const f32x4 v0 = acc[ai][bj][m][0] * s0, v1 = acc[ai][bj][m][1] * s1;
                    u32x4 w; w.x = cvt_pk_bf16(v0[0], v0[1]); w.y = cvt_pk_bf16(v0[2], v0[3]); w.z = cvt_pk_bf16(v1[0], v1[1]); w.w = cvt_pk_bf16(v1[2], v1[3]);
                    *(u32x4*)rowp = w; } }
    }
};
struct EpiProj {
    bf16_t* RKV; bf16_t* POOL; bf16_t* GATES; float* LOR; const float* gbias;
    __device__ __forceinline__ void operator()(const f32x4 (&acc)[2][2][4][2], const Unit& u, int wr, int wc, int fr, int fq) const {
        const int row0 = u.pm * BM + wr * 64 + fr, cw = wc * 32 + 8 * fq;
        if (u.pn >= 16) {
            const int col0 = (u.pn - 16) * BM + cw;
#pragma unroll
            for (int ai = 0; ai < 2; ++ai)
#pragma unroll
                for (int m = 0; m < 4; ++m) { float* rowp = LOR + (size_t)(row0 + ai * HALF + m * 16) * 512 + col0;
#pragma unroll
                    for (int bj = 0; bj < 2; ++bj) { *(f32x4*)(rowp + bj * HALF) = acc[ai][bj][m][0]; *(f32x4*)(rowp + bj * HALF + 4) = acc[ai][bj][m][1]; } }
            return;
        }
        bf16_t* base; int ldc, col0; const bool gate = (u.pn >= 8);
        if (u.pn < 6) { base = RKV; ldc = 1536; col0 = u.pn * BM + cw; }
        else if (u.pn < 8) { base = POOL; ldc = 512; col0 = (u.pn - 6) * BM + cw; }
        else { base = GATES; ldc = 2048; col0 = (u.pn - 8) * BM + cw; }
#pragma unroll
        for (int bj = 0; bj < 2; ++bj) {
            f32x4 b0 = (f32x4){0.f, 0.f, 0.f, 0.f}, b1 = b0;
            if (gate) { b0 = *(const f32x4*)(gbias + col0 + bj * HALF); b1 = *(const f32x4*)(gbias + col0 + bj * HALF + 4); }
#pragma unroll
            for (int ai = 0; ai < 2; ++ai)
#pragma unroll
                for (int m = 0; m < 4; ++m) { bf16_t* rowp = base + (size_t)(row0 + ai * HALF + m * 16) * ldc + col0 + bj * HALF;
                    f32x4 v0 = acc[ai][bj][m][0] + b0, v1 = acc[ai][bj][m][1] + b1;
                    if (gate) {
#pragma unroll
                        for (int j = 0; j < 4; ++j) { v0[j] = __builtin_amdgcn_rcpf(1.0f + __expf(-v0[j])); v1[j] = __builtin_amdgcn_rcpf(1.0f + __expf(-v1[j])); } }
                    u32x4 w; w.x = cvt_pk_bf16(v0[0], v0[1]); w.y = cvt_pk_bf16(v0[2], v0[3]); w.z = cvt_pk_bf16(v1[0], v1[1]); w.w = cvt_pk_bf16(v1[2], v1[3]);
                    *(u32x4*)rowp = w; } }
    }
};
struct EpiLoraB {
    float* DW; bf16_t* DA; bf16_t* G; const float* w0; const float* a0;
    __device__ __forceinline__ void operator()(const f32x4 (&acc)[2][2][4][2], const Unit& u, int wr, int wc, int fr, int fq) const {
        const unsigned row0 = u.pm * BM + wr * 64 + fr, col0 = (u.pn & 1) * BM + wc * 32 + 8 * fq;
        const int kind = u.pn >> 1;
        const float* bias = kind == 0 ? w0 : a0; bf16_t* ob = kind == 1 ? DA : G;
#pragma unroll
        for (int bj = 0; bj < 2; ++bj) {
            f32x4 b0 = (f32x4){0.f, 0.f, 0.f, 0.f}, b1 = b0;
            if (kind < 2) { b0 = *(const f32x4*)(bias + col0 + bj * HALF); b1 = *(const f32x4*)(bias + col0 + bj * HALF + 4); }
#pragma unroll
            for (int ai = 0; ai < 2; ++ai)
#pragma unroll
                for (int m = 0; m < 4; ++m) { const unsigned off = (row0 + ai * HALF + m * 16) * 512u + col0 + bj * HALF;
                    f32x4 v0 = acc[ai][bj][m][0] + b0, v1 = acc[ai][bj][m][1] + b1;
                    if (kind < 2) {
#pragma unroll
                        for (int j = 0; j < 4; ++j) { v0[j] = __builtin_amdgcn_rcpf(1.0f + __expf(-v0[j])); v1[j] = __builtin_amdgcn_rcpf(1.0f + __expf(-v1[j])); } }
                    if (kind == 0) {
#pragma unroll
                        for (int j = 0; j < 4; ++j) { v0[j] = __expf(-0.6065306597126334f * v0[j]); v1[j] = __expf(-0.6065306597126334f * v1[j]); }
                        *(f32x4*)(DW + off) = v0; *(f32x4*)(DW + off + 4) = v1;
                    } else {
                        u32x4 w; w.x = cvt_pk_bf16(v0[0], v0[1]); w.y = cvt_pk_bf16(v0[2], v0[3]); w.z = cvt_pk_bf16(v1[0], v1[1]); w.w = cvt_pk_bf16(v1[2], v1[3]);
                        *(u32x4*)(ob + off) = w; }
                    asm volatile("" ::: "memory"); } }
    }
};
struct EpiMerge {
    bf16_t* O; const bf16_t* GATES;
    __device__ __forceinline__ void mid(f32x4 (&acc)[2][2][4][2], const Unit& u, int wr, int wc, int fr, int fq) const {
        const int row0 = u.pm * BM + wr * 64 + fr, col0 = u.pn * BM + wc * 32 + 8 * fq;
#pragma unroll
        for (int ai = 0; ai < 2; ++ai)
#pragma unroll
            for (int m = 0; m < 4; ++m) { const bf16_t* gp = GATES + (size_t)(row0 + ai * HALF + m * 16) * 2048 + col0;
#pragma unroll
                for (int bj = 0; bj < 2; ++bj) { const u32x4 a = *(const u32x4*)(gp + bj * HALF), b = *(const u32x4*)(gp + 1024 + bj * HALF);
                    f32x4 r0, r1;
                    r0[0] = bf_lo(a.x) * __builtin_amdgcn_rcpf(bf_lo(b.x)); r0[1] = bf_hi(a.x) * __builtin_amdgcn_rcpf(bf_hi(b.x)); r0[2] = bf_lo(a.y) * __builtin_amdgcn_rcpf(bf_lo(b.y)); r0[3] = bf_hi(a.y) * __builtin_amdgcn_rcpf(bf_hi(b.y));
                    r1[0] = bf_lo(a.z) * __builtin_amdgcn_rcpf(bf_lo(b.z)); r1[1] = bf_hi(a.z) * __builtin_amdgcn_rcpf(bf_hi(b.z)); r1[2] = bf_lo(a.w) * __builtin_amdgcn_rcpf(bf_lo(b.w)); r1[3] = bf_hi(a.w) * __builtin_amdgcn_rcpf(bf_hi(b.w));
                    acc[ai][bj][m][0] *= r0; acc[ai][bj][m][1] *= r1; }
                asm volatile("" ::: "memory"); }
    }
    __device__ __forceinline__ void operator()(const f32x4 (&acc)[2][2][4][2], const Unit& u, int wr, int wc, int fr, int fq) const {
        const int row0 = u.pm * BM + wr * 64 + fr, col0 = u.pn * BM + wc * 32 + 8 * fq;
#pragma unroll
        for (int ai = 0; ai < 2; ++ai)
#pragma unroll
            for (int m = 0; m < 4; ++m) { const size_t ro = (size_t)(row0 + ai * HALF + m * 16);
#pragma unroll
                for (int bj = 0; bj < 2; ++bj) { const u32x4 b = *(const u32x4*)(GATES + ro * 2048 + 1024 + col0 + bj * HALF);
                    const f32x4 v0 = acc[ai][bj][m][0], v1 = acc[ai][bj][m][1];
                    u32x4 w; w.x = cvt_pk_bf16(v0[0] * bf_lo(b.x), v0[1] * bf_hi(b.x)); w.y = cvt_pk_bf16(v0[2] * bf_lo(b.y), v0[3] * bf_hi(b.y));
                    w.z = cvt_pk_bf16(v1[0] * bf_lo(b.z), v1[1] * bf_hi(b.z)); w.w = cvt_pk_bf16(v1[2] * bf_lo(b.w), v1[3] * bf_hi(b.w));
                    *(u32x4*)(O + ro * 1024 + col0 + bj * HALF) = w; } }
    }
};
}

constexpr int NWAVES = 8;
constexpr int BATCH = 16, SEQ = 2048, D = 1024, FF = 2816, RW = 512, PW = 512, NH = 8, HS = 64;
constexpr int M = BATCH * SEQ;
constexpr int NPROJ = 4096 + 512;
constexpr float RMS_EPS = 1e-6f, GN_EPS = 64e-5f;
constexpr int NPHASE = 13;
constexpr int N_LAUNCHES = MK_N_LAUNCHES;

constexpr size_t MiB = 1u << 20;
constexpr size_t WS_CTL = 0, CTL_ZERO_BYTES = 1 * MiB;
constexpr size_t WS_W1GU = 1 * MiB;
constexpr size_t WS_W1D = 12 * MiB;
constexpr size_t WS_WIN = 18 * MiB;
constexpr size_t WS_WLB = 27 * MiB;
constexpr size_t WS_WPL = 27 * MiB + 768 * 1024;
constexpr size_t WS_WRP = 28 * MiB;
constexpr size_t WS_WO = 30 * MiB;
constexpr size_t WS_W2GU = 32 * MiB;
constexpr size_t WS_W2D = 43 * MiB;
constexpr size_t WS_HN = 49 * MiB;
constexpr size_t WS_ACT = 113 * MiB;
constexpr size_t WS_F = 289 * MiB;
constexpr size_t WS_DW = WS_HN;
constexpr size_t WS_RKV = 113 * MiB;
constexpr size_t WS_POOL = 209 * MiB;
constexpr size_t WS_G = WS_POOL;
constexpr size_t WS_GATES = 241 * MiB;
constexpr size_t WS_LOR = 369 * MiB;
constexpr size_t WS_YRP = WS_LOR;
constexpr size_t WS_MIX = 433 * MiB;
constexpr size_t WS_DA = 465 * MiB;
constexpr size_t WS_LIN = WS_W1GU;
constexpr size_t WS_MG = WS_RKV;
constexpr size_t WS_MO = WS_GATES;
constexpr size_t WS_END = 497 * MiB;
constexpr int CW_BAR = 4096;

constexpr int RING_OFF = 0, RING_BYTES = 131072;
constexpr int LDSCTL_OFF = RING_BYTES, MISC_OFF = LDSCTL_OFF + 320;
constexpr int LDS_BYTES = 147456;

#define GAS __attribute__((address_space(1)))
#define LAS __attribute__((address_space(3)))
typedef unsigned short bf16;
typedef unsigned v4u __attribute__((ext_vector_type(4)));
typedef unsigned v2u __attribute__((ext_vector_type(2)));
typedef float f32x4 __attribute__((ext_vector_type(4)));
typedef float f32x2 __attribute__((ext_vector_type(2)));
typedef GAS unsigned gu32;
#define RLX_AGENT __ATOMIC_RELAXED, __HIP_MEMORY_SCOPE_AGENT
#define LDS_WAIT() asm volatile("s_waitcnt lgkmcnt(0)" ::: "memory")
#define VM_WAIT() asm volatile("s_waitcnt vmcnt(0)" ::: "memory")
__device__ __forceinline__ unsigned f2bf(float f) { unsigned u = __builtin_bit_cast(unsigned, f); return (u + 0x7fffu + ((u >> 16) & 1u)) >> 16; }
__device__ __forceinline__ unsigned pk2(float lo, float hi) { return f2bf(lo) | (f2bf(hi) << 16); }
__device__ __forceinline__ float bf2f(unsigned short b) { return __builtin_bit_cast(float, (unsigned)b << 16); }

#define XB_TMO      128
#define XB_XCNT(j)  (256  + 64 * (j))
#define XB_XSUB(j)  (1280 + 64 * (j))
#define XB_XGEN(j)  (2304 + 64 * (j))
#define XB_TOP      3328
#define XB_TOPGEN   3392
#define XCD_BAR_WORDS 3456
#define XB_SPIN_CAP (1u << 20)
__device__ __forceinline__ unsigned xb_ld(unsigned* p)              { return __hip_atomic_load(p, __ATOMIC_RELAXED, __HIP_MEMORY_SCOPE_AGENT); }
__device__ __forceinline__ unsigned xb_add(unsigned* p, unsigned v) { return __hip_atomic_fetch_add(p, v, __ATOMIC_RELAXED, __HIP_MEMORY_SCOPE_AGENT); }
__device__ __forceinline__ unsigned xb_xcc_id() { return (unsigned)__builtin_amdgcn_s_getreg((3 << 11) | 20) & 0xFu; }
#define XB_SPIN(cond, bar) do { unsigned _sp = 0; while (cond) { __builtin_amdgcn_s_sleep(1); \
    if ((++_sp & 255u) == 0u) { if (xb_ld(&(bar)[XB_TMO])) break; if (_sp > XB_SPIN_CAP) { atomicAdd(&(bar)[XB_TMO], 1u); break; } } } } while (0)
struct XcdBarrier { unsigned* bar; unsigned x; volatile LAS unsigned* st; };
__device__ __forceinline__ XcdBarrier xcd_barrier_post(unsigned* bar, volatile LAS unsigned* st) {
    XcdBarrier b; b.bar = bar; b.x = xb_xcc_id(); b.st = st;
    if (threadIdx.x == 0) (void)xb_add(&bar[XB_XCNT(b.x)], 1u);
    return b;
}
__device__ __forceinline__ void xcd_barrier_complete(unsigned* bar, unsigned x, unsigned& nloc, unsigned& nx) {
    const unsigned G = gridDim.x * gridDim.y * gridDim.z;
    unsigned sum, cnt, mine, sp = 0u;
    for (;;) {
        sum = 0u; cnt = 0u; mine = 0u;
#pragma unroll
        for (unsigned j = 0; j < 16; ++j) { const unsigned c = xb_ld(&bar[XB_XCNT(j)]); sum += c; cnt += (c > 0u) ? 1u : 0u; mine = (j == x) ? c : mine; }
        if (sum == G) break;
        __builtin_amdgcn_s_sleep(1);
        if ((++sp & 255u) == 0u) { if (xb_ld(&bar[XB_TMO])) break; if (sp > XB_SPIN_CAP) { atomicAdd(&bar[XB_TMO], 1u); break; } }
    }
    nloc = mine > 0u ? mine : 1u; nx = cnt > 0u ? cnt : 1u;
}
__device__ __forceinline__ void xcd_barrier(const XcdBarrier& b) {
    asm volatile("s_waitcnt vmcnt(0)" ::: "memory");
    __syncthreads();
    if (threadIdx.x == 0) {
        unsigned* bar = b.bar;
        __builtin_amdgcn_s_waitcnt(0);
        unsigned nloc = b.st[0], nx = b.st[1];
        if (nloc == 0u) { xcd_barrier_complete(bar, b.x, nloc, nx); b.st[0] = nloc; b.st[1] = nx; }
        const unsigned old = xb_add(&bar[XB_XSUB(b.x)], 1u);
        const unsigned gen = old / nloc;
        if (old + 1u == (gen + 1u) * nloc) {
            __builtin_amdgcn_fence(__ATOMIC_RELEASE, "agent");
            asm volatile("s_waitcnt vmcnt(0)" ::: "memory");
            const unsigned og = xb_add(&bar[XB_TOP], 1u);
            const unsigned tg = og / nx;
            if (og + 1u == (tg + 1u) * nx) xb_add(&bar[XB_TOPGEN], 1u);
            else XB_SPIN(xb_ld(&bar[XB_TOPGEN]) == tg, bar);
            __builtin_amdgcn_fence(__ATOMIC_ACQUIRE, "agent");
            xb_add(&bar[XB_XGEN(b.x)], 1u);
            asm volatile("s_waitcnt vmcnt(0)" ::: "memory");
        } else {
            XB_SPIN(xb_ld(&bar[XB_XGEN(b.x)]) == gen, bar);
            __builtin_amdgcn_fence(__ATOMIC_ACQUIRE, "agent");
            asm volatile("s_waitcnt vmcnt(0)" ::: "memory");
        }
    }
    __syncthreads();
}

struct Args { const float* in[30]; float* out; unsigned char* ws; int ph_lo, ph_hi, li, pad; };

__device__ __forceinline__ float wave_sum(float v) {
#pragma unroll
    for (int o = 1; o < 64; o <<= 1) v += __shfl_xor(v, o);
    return v;
}

__device__ __forceinline__ void tr_item(const float* src, int ldsrc, int src_col0, int k0, const float* mu, float s0, float s1,
                                        bf16* dst, int dst_ld, int dst_row0, int dst_k0, LAS float* scr, int lane) {
#pragma unroll 8
    for (int i = 0; i < 32; ++i) { const int kk = 2 * i + (lane >> 5); float v = src[(size_t)(k0 + kk) * ldsrc + src_col0 + (lane & 31)];
        if (mu) v *= (s0 + s1 * mu[k0 + kk]);
        scr[kk * 33 + (lane & 31)] = v; }
    LDS_WAIT(); asm volatile("" ::: "memory");
    const int c = lane & 7;
#pragma unroll
    for (int j = 0; j < 4; ++j) { const int n = (lane >> 3) + 8 * j; const LAS float* s = scr + (8 * c) * 33 + n;
        v4u o; o.x = pk2(s[0 * 33], s[1 * 33]); o.y = pk2(s[2 * 33], s[3 * 33]); o.z = pk2(s[4 * 33], s[5 * 33]); o.w = pk2(s[6 * 33], s[7 * 33]);
        *(GAS v4u*)(dst + (size_t)(dst_row0 + n) * dst_ld + dst_k0 + 8 * c) = o; }
    LDS_WAIT(); asm volatile("" ::: "memory");
}
__device__ __forceinline__ void tr_gu(const float* wg, const float* wu, bf16* dst, int item, LAS float* scr, int lane) {
    const int rb = item >> 4, kb = item & 15; const int pn = rb >> 3, bj = (rb >> 2) & 1, xb = rb & 3;
    tr_item(bj ? wu : wg, FF, pn * 128 + xb * 32, kb * 64, nullptr, 1.f, 0.f, dst, D, rb * 32, kb * 64, scr, lane);
}

__device__ __forceinline__ void res_norm_row(const float* src, const float* base, float* out, float rscale, const float* gA, bf16* hn, const float* gB, int lane) {
    f32x4 v[4]; float s = 0.f;
#pragma unroll
    for (int j = 0; j < 4; ++j) { v[j] = *((const GAS f32x4*)src + lane + 64 * j); s += (v[j].x * v[j].x + v[j].y * v[j].y) + (v[j].z * v[j].z + v[j].w * v[j].w); }
    const float r = rscale * rsqrtf(wave_sum(s) * (1.f / D) + RMS_EPS); float s2 = 0.f;
#pragma unroll
    for (int j = 0; j < 4; ++j) { const f32x4 g = *((const GAS f32x4*)gA + lane + 64 * j); const f32x4 b = *((const GAS f32x4*)base + lane + 64 * j);
        v[j] = b + v[j] * r * g; *((GAS f32x4*)out + lane + 64 * j) = v[j]; s2 += (v[j].x * v[j].x + v[j].y * v[j].y) + (v[j].z * v[j].z + v[j].w * v[j].w); }
    if (hn) {
        const float r2 = rsqrtf(wave_sum(s2) * (1.f / D) + RMS_EPS);
#pragma unroll
        for (int j = 0; j < 4; ++j) { const f32x4 g = *((const GAS f32x4*)gB + lane + 64 * j); const f32x4 o = v[j] * r2 * g;
            v2u w; w.x = pk2(o.x, o.y); w.y = pk2(o.z, o.w); *((GAS v2u*)hn + lane + 64 * j) = w; }
    }
}
__device__ __forceinline__ void norm_row_bf16(const float* src, const float* gA, bf16* hn, int lane) {
    f32x4 v[4]; float s = 0.f;
#pragma unroll
    for (int j = 0; j < 4; ++j) { v[j] = *((const GAS f32x4*)src + lane + 64 * j); s += (v[j].x * v[j].x + v[j].y * v[j].y) + (v[j].z * v[j].z + v[j].w * v[j].w); }
    const float r = rsqrtf(wave_sum(s) * (1.f / D) + RMS_EPS);
#pragma unroll
    for (int j = 0; j < 4; ++j) { const f32x4 g = *((const GAS f32x4*)gA + lane + 64 * j); const f32x4 o = v[j] * r * g;
        v2u w; w.x = pk2(o.x, o.y); w.y = pk2(o.z, o.w); *((GAS v2u*)hn + lane + 64 * j) = w; }
}

template <int CTRL> __device__ __forceinline__ float dpp_add(float x) {
    return x + __builtin_bit_cast(float, __builtin_amdgcn_update_dpp(0, __builtin_bit_cast(int, x), CTRL, 0xf, 0xf, false));
}
__device__ __forceinline__ float allreduce16(float x) {
    x = dpp_add<0x128>(x); x = dpp_add<0x124>(x); x = dpp_add<0x122>(x); x = dpp_add<0x121>(x); return x;
}

constexpr int TC = 16;
constexpr int RSTRIDE = 456;
constexpr int RBUF = TC * RSTRIDE;

__global__ void __launch_bounds__(NWAVES * 64, 2) fwd_kernel(Args args) {
    extern __shared__ __attribute__((aligned(16))) unsigned char lds[];
    LAS unsigned char* L = (LAS unsigned char*)lds;
    volatile LAS unsigned* MISC = (volatile LAS unsigned*)(L + MISC_OFF);
    const int tid = threadIdx.x, lane = tid & 63, wave = __builtin_amdgcn_readfirstlane(tid >> 6);
    const int G = gridDim.x, bx = blockIdx.x;
    const int gw = bx * NWAVES + wave, NGW = G * NWAVES;
    typedef const __attribute__((address_space(4))) Args* KArgs;
#define AP ((KArgs)__builtin_amdgcn_kernarg_segment_ptr())
#define ARG(k) (AP->in[k])
#define WSB (AP->ws)
#define OUTP (AP->out)
#define XIN ARG(0)
#define GAINS ARG(1)
#define ctl ((gu32*)(WSB + WS_CTL))
#define W1GU ((bf16*)(WSB + WS_W1GU))
#define W1D ((bf16*)(WSB + WS_W1D))
#define WIN ((bf16*)(WSB + WS_WIN))
#define WLB ((bf16*)(WSB + WS_WLB))
#define WPL ((bf16*)(WSB + WS_WPL))
#define WRP ((bf16*)(WSB + WS_WRP))
#define WO ((bf16*)(WSB + WS_WO))
#define W2GU ((bf16*)(WSB + WS_W2GU))
#define W2D ((bf16*)(WSB + WS_W2D))
#define HN ((bf16*)(WSB + WS_HN))
#define ACT ((bf16*)(WSB + WS_ACT))
#define Fb ((float*)(WSB + WS_F))
#define DW ((float*)(WSB + WS_DW))
#define RKV ((bf16*)(WSB + WS_RKV))
#define POOL ((bf16*)(WSB + WS_POOL))
#define Gb ((bf16*)(WSB + WS_G))
#define GATES ((bf16*)(WSB + WS_GATES))
#define LOR ((float*)(WSB + WS_LOR))
#define YRP ((bf16*)(WSB + WS_YRP))
#define LIN ((bf16*)(WSB + WS_LIN))
#define MIX ((bf16*)(WSB + WS_MIX))
#define DA ((bf16*)(WSB + WS_DA))
#define MG ((bf16*)(WSB + WS_MG))
#define MO ((float*)(WSB + WS_MO))

    for (int u = tid; u < (LDS_BYTES - LDSCTL_OFF) / 4; u += NWAVES * 64) ((LAS unsigned*)(L + LDSCTL_OFF))[u] = 0u;
    __syncthreads();
    XcdBarrier bar; bar.bar = (unsigned*)(ctl + CW_BAR); bar.x = 0; bar.st = nullptr;
    if (N_LAUNCHES == 1) bar = xcd_barrier_post((unsigned*)(ctl + CW_BAR), MISC + 8);
#define GRID_BAR() do { if (N_LAUNCHES == 1) xcd_barrier(bar); } while (0)
    const int lo = AP->ph_lo, hi = AP->ph_hi;
#ifndef PHASE_MASK
#define PHASE_MASK 0xFFFF
#endif
#define IN(k) (((PHASE_MASK >> (k)) & 1) && lo <= (k) && (k) < hi)
#define BOTH(k) (IN(k) && IN((k) + 1))

    if (IN(0)) {
        LAS float* scr = (LAS float*)(L + RING_OFF + wave * 16384);
        constexpr int I_GU = 176 * 16, I_D = 32 * 44, I_WIN = 128 * 16, I_LORA = 16 * 16, I_BR = 32 * 8, I_WO = 32 * 16;
        constexpr int NITEMS = 2 * I_GU + 2 * I_D + I_WIN + I_LORA + 2 * I_BR + I_WO;
        for (int it = gw; it < NITEMS; it += NGW) {
            int r = it;
            if (r < I_GU) { tr_gu(ARG(2), ARG(3), W1GU, r, scr, lane); continue; } r -= I_GU;
            if (r < I_GU) { tr_gu(ARG(27), ARG(28), W2GU, r, scr, lane); continue; } r -= I_GU;
            if (r < I_D) { tr_item(ARG(4), D, (r & 31) * 32, (r >> 5) * 64, nullptr, 1.f, 0.f, W1D, FF, (r & 31) * 32, (r >> 5) * 64, scr, lane); continue; } r -= I_D;
            if (r < I_D) { tr_item(ARG(29), D, (r & 31) * 32, (r >> 5) * 64, nullptr, 1.f, 0.f, W2D, FF, (r & 31) * 32, (r >> 5) * 64, scr, lane); continue; } r -= I_D;
            if (r < I_WIN) { tr_item(ARG(5), 4096, (r & 127) * 32, (r >> 7) * 64, nullptr, 1.f, 0.f, WIN, D, (r & 127) * 32, (r >> 7) * 64, scr, lane); continue; } r -= I_WIN;
            if (r < I_LORA) {
                const int rb = r >> 4, kb = r & 15, half = rb >> 3, q = rb & 7;
                const float* src; int ld, c0, which;
                if (q < 2) { src = ARG(10); ld = 64; c0 = q * 32; which = 0; } else if (q < 4) { src = ARG(13); ld = 64; c0 = (q - 2) * 32; which = 1; } else { src = ARG(15); ld = 128; c0 = (q - 4) * 32; which = 2; }
                tr_item(src, ld, c0, kb * 64, ARG(8) + which * D, half ? 0.f : 1.f, half ? 1.f : -1.f, WIN, D, 4096 + rb * 32, kb * 64, scr, lane); continue; } r -= I_LORA;
            if (r < I_BR) { tr_item(ARG(24), D, (r & 31) * 32, (r >> 5) * 64, nullptr, 1.f, 0.f, WRP, D, (r & 31) * 32, (r >> 5) * 64, scr, lane); continue; } r -= I_BR;
            if (r < I_BR) { tr_item(ARG(25), D, (r & 31) * 32, (r >> 5) * 64, nullptr, 1.f, 0.f, WRP, D, (r & 31) * 32, 512 + (r >> 5) * 64, scr, lane); continue; } r -= I_BR;
            tr_item(ARG(26), D, (r & 31) * 32, (r >> 5) * 64, nullptr, 1.f, 0.f, WO, D, (r & 31) * 32, (r >> 5) * 64, scr, lane);
        }
        for (int ch = bx * (NWAVES * 64) + tid; ch < (1536 + 512) * 32; ch += G * NWAVES * 64) {
            const int n = ch >> 5, k0 = (ch & 31) * 8; float v[8];
#pragma unroll
            for (int j = 0; j < 8; ++j) { const int k = k0 + j; float t = 0.f;
                if (n < 512) { if (k < 64) t = ARG(11)[k * 512 + n]; }
                else if (n < 1024) { if (k >= 64 && k < 128) t = ARG(14)[(k - 64) * 512 + (n - 512)]; }
                else if (n < 1536) { if (k >= 128) t = ARG(16)[(k - 128) * 512 + (n - 1024)]; }
                else { const int nn = n - 1536, g = nn >> 7; if ((k >> 7) == (g & 1)) t = ARG(22)[(g * 128 + (k & 127)) * 128 + (nn & 127)]; }
                v[j] = t; }
            v4u o; o.x = pk2(v[0], v[1]); o.y = pk2(v[2], v[3]); o.z = pk2(v[4], v[5]); o.w = pk2(v[6], v[7]);
            *(GAS v4u*)((n < 1536 ? WLB + (size_t)n * 256 : WPL + (size_t)(n - 1536) * 256) + k0) = o;
        }
        for (int m = gw; m < M; m += NGW) norm_row_bf16(XIN + (size_t)m * D, GAINS, HN + (size_t)m * D, lane);
        if (BOTH(0)) GRID_BAR();
    }
    if (IN(1)) {
        pg8::Gemm g{HN, W1GU}; pg8::StaticOrder S; S.init(M, 2 * FF, G, bx);
        pg8::EpiSwiGLU E{ACT, FF};
        pg8::gemm_phase<pg8::EpiSwiGLU, true, true, 1, D, D, D, 0>(L + RING_OFF, g, S, E);
        if (BOTH(1)) GRID_BAR();
    }
    if (IN(2)) {
        pg8::Gemm g{ACT, W1D}; pg8::StaticOrder S; S.init(M, D, G, bx);
        pg8::EpiF32 E{Fb, D};
        pg8::gemm_phase<pg8::EpiF32, true, true, 1, FF, FF, FF, 0>(L + RING_OFF, g, S, E);
        if (BOTH(2)) GRID_BAR();
    }
    if (IN(3)) {
        for (int m = gw; m < M; m += NGW) res_norm_row(Fb + (size_t)m * D, XIN + (size_t)m * D, OUTP + (size_t)m * D, 0.5f, GAINS + 1 * D, HN + (size_t)m * D, GAINS + 2 * D, lane);
        if (BOTH(3)) GRID_BAR();
    }
    if (IN(4)) {
        pg8::Gemm g{HN, WIN}; pg8::StaticOrder S; S.init(M, NPROJ, G, bx);
        pg8::EpiProj E{RKV, POOL, GATES, LOR, ARG(6)};
        pg8::gemm_phase<pg8::EpiProj, true, true, 1, D, D, D, 0>(L + RING_OFF, g, S, E);
        if (BOTH(4)) GRID_BAR();
    }
    if (IN(5)) {
        for (int m = gw; m < M; m += NGW) {
            const int t = m & (SEQ - 1);
            {
                const int c = lane * 4;
                f32x4 a = *(const GAS f32x4*)(LOR + (size_t)m * 512 + c);
                if (t > 0) a += *(const GAS f32x4*)(LOR + (size_t)(m - 1) * 512 + 256 + c);
                f32x4 o;
                if (c < 64) { o.x = tanhf(a.x); o.y = tanhf(a.y); o.z = tanhf(a.z); o.w = tanhf(a.w); }
                else if (c < 128) o = a;
                else { o.x = 1.f / (1.f + expf(-a.x)); o.y = 1.f / (1.f + expf(-a.y)); o.z = 1.f / (1.f + expf(-a.z)); o.w = 1.f / (1.f + expf(-a.w)); }
                v2u w; w.x = pk2(o.x, o.y); w.y = pk2(o.z, o.w); *(GAS v2u*)(LIN + (size_t)m * 256 + c) = w;
            }
            {
                const int c = lane * 8, win = 2 << (lane >> 4);
                const int n = (t + 1 < win) ? (t + 1) : win;
                float s[8];
#pragma unroll
                for (int j = 0; j < 8; ++j) s[j] = 0.f;
                float self[8];
                for (int q = 0; q < n; ++q) { const v4u p = *(const GAS v4u*)(POOL + (size_t)(m - q) * 512 + c);
                    const float f0 = pg8::bf_lo(p.x), f1 = pg8::bf_hi(p.x), f2 = pg8::bf_lo(p.y), f3 = pg8::bf_hi(p.y), f4 = pg8::bf_lo(p.z), f5 = pg8::bf_hi(p.z), f6 = pg8::bf_lo(p.w), f7 = pg8::bf_hi(p.w);
                    if (q == 0) { self[0] = f0; self[1] = f1; self[2] = f2; self[3] = f3; self[4] = f4; self[5] = f5; self[6] = f6; self[7] = f7; }
                    s[0] += f0; s[1] += f1; s[2] += f2; s[3] += f3; s[4] += f4; s[5] += f5; s[6] += f6; s[7] += f7; }
                const float inv = 1.f / (float)n;
                v4u o; o.x = pk2(s[0] * inv - self[0], s[1] * inv - self[1]); o.y = pk2(s[2] * inv - self[2], s[3] * inv - self[3]);
                o.z = pk2(s[4] * inv - self[4], s[5] * inv - self[5]); o.w = pk2(s[6] * inv - self[6], s[7] * inv - self[7]);
                *(GAS v4u*)(MIX + (size_t)m * 512 + c) = o;
            }
        }
        if (BOTH(5)) GRID_BAR();
    }
    if (IN(6)) {
        pg8::Gemm g{LIN, WLB}; pg8::StaticOrder S; S.init(M, 1536, G, bx);
        pg8::EpiLoraB E{DW, DA, Gb, ARG(9), ARG(12)};
        pg8::gemm_phase<pg8::EpiLoraB, true, true, 1, 256, 256, 256, 0>(L + RING_OFF, g, S, E);
        if (BOTH(6)) GRID_BAR();
    }
    if (IN(7)) {
        if (bx < BATCH * NH) {
            const int b = bx >> 3, h = bx & 7, cb = h * HS;
            LAS float* buf = (LAS float*)(L + RING_OFF);
            LAS float* ybuf = buf + 2 * RBUF;
            const float* mu_rkv = ARG(7);
            const int j = lane;
            const float mu_r = mu_rkv[cb + j], mu_k = mu_rkv[RW + cb + j], mu_v = mu_rkv[2 * RW + cb + j];
            const float kkw = ARG(17)[cb + j], kaw = ARG(18)[cb + j], rkw = ARG(19)[cb + j], lnw = ARG(20)[cb + j], lnb = ARG(21)[cb + j];
            const size_t row0 = (size_t)b * SEQ;
            unsigned short pr[3], pk[3], pv[3], pa[2], pg[2]; float pw[2];
#define LOADRAW(chunk) do { const int t0_ = (chunk) * TC + 2 * wave; \
            _Pragma("unroll") for (int q = 0; q < 3; ++q) { const int tt_ = t0_ - 1 + q; if (tt_ >= 0) { const bf16* p_ = RKV + (row0 + tt_) * 1536 + cb + j; pr[q] = p_[0]; pk[q] = p_[512]; pv[q] = p_[1024]; } else { pr[q] = 0; pk[q] = 0; pv[q] = 0; } } \
            _Pragma("unroll") for (int q = 0; q < 2; ++q) { const size_t o_ = (row0 + t0_ + q) * 512 + cb + j; pw[q] = DW[o_]; pa[q] = DA[o_]; pg[q] = Gb[o_]; } } while (0)
            LOADRAW(0);
            const int jq = lane & 15, ig = lane >> 4, r0 = 8 * wave + 2 * ig;
            f32x4 s0 = (f32x4){0.f, 0.f, 0.f, 0.f}, s1 = s0;
            for (int ch = 0; ch < SEQ / TC; ++ch) {
                LAS float* cb_ = buf + (ch & 1) * RBUF;
#pragma unroll
                for (int q = 0; q < 2; ++q) {
                    const float r_c = bf2f(pr[q + 1]), r_p = bf2f(pr[q]), k_c = bf2f(pk[q + 1]), k_p = bf2f(pk[q]), v_c = bf2f(pv[q + 1]), v_p = bf2f(pv[q]);
                    const float r = r_c + (r_p - r_c) * mu_r, k = k_c + (k_p - k_c) * mu_k, v = v_c + (v_p - v_c) * mu_v;
                    const float w = pw[q], a = bf2f(pa[q]), gg = bf2f(pg[q]);
                    float kk = k * kkw; const float nrm = sqrtf(wave_sum(kk * kk)); kk = kk / fmaxf(nrm, 1e-12f);
                    const float k2 = k * (1.f + (a - 1.f) * kaw);
                    const float bv = kk * a;
                    const float br = wave_sum(bv * r), kr = wave_sum(k2 * r), bon = wave_sum(r * k2 * rkw);
                    LAS float* st = cb_ + (2 * wave + q) * RSTRIDE;
                    st[j] = w; st[64 + j] = -kk; st[128 + j] = bv; st[192 + j] = k2; st[256 + j] = w * r; st[320 + j] = v; st[384 + j] = gg;
                    if (j == 0) { st[448] = br; st[449] = kr; st[450] = bon; }
                }
                if (ch + 1 < SEQ / TC) LOADRAW(ch + 1);
                __syncthreads();
#pragma unroll 4
                for (int tt = 0; tt < TC; ++tt) {
                    const LAS float* st = cb_ + tt * RSTRIDE;
                    const f32x4 w4 = *(const LAS f32x4*)(st + 4 * jq), a4 = *(const LAS f32x4*)(st + 64 + 4 * jq), b4 = *(const LAS f32x4*)(st + 128 + 4 * jq),
                                k4 = *(const LAS f32x4*)(st + 192 + 4 * jq), q4 = *(const LAS f32x4*)(st + 256 + 4 * jq);
                    const f32x2 v2 = *(const LAS f32x2*)(st + 320 + r0); const f32x2 sc = *(const LAS f32x2*)(st + 448);
                    float d0 = (s0.x * a4.x + s0.y * a4.y) + (s0.z * a4.z + s0.w * a4.w), d1 = (s1.x * a4.x + s1.y * a4.y) + (s1.z * a4.z + s1.w * a4.w);
                    float e0 = (s0.x * q4.x + s0.y * q4.y) + (s0.z * q4.z + s0.w * q4.w), e1 = (s1.x * q4.x + s1.y * q4.y) + (s1.z * q4.z + s1.w * q4.w);
                    d0 = allreduce16(d0); d1 = allreduce16(d1); e0 = allreduce16(e0); e1 = allreduce16(e1);
                    s0 = s0 * w4 + d0 * b4 + v2.x * k4; s1 = s1 * w4 + d1 * b4 + v2.y * k4;
                    if (jq == 0) { f32x2 y; y.x = e0 + d0 * sc.x + v2.x * sc.y; y.y = e1 + d1 * sc.x + v2.y * sc.y; *(LAS f32x2*)(ybuf + tt * 64 + r0) = y; }
                }
                __syncthreads();
#pragma unroll
                for (int q = 0; q < 2; ++q) {
                    const int tt = 2 * wave + q; const LAS float* st = cb_ + tt * RSTRIDE;
                    const float y = ybuf[tt * 64 + j], v = st[320 + j], gg = st[384 + j], bon = st[450];
                    const float mean = wave_sum(y) * (1.f / 64.f); const float dlt = y - mean; const float var = wave_sum(dlt * dlt) * (1.f / 64.f);
                    const float o = (dlt * rsqrtf(var + GN_EPS) * lnw + lnb + bon * v) * gg;
                    YRP[(row0 + (size_t)ch * TC + tt) * 1024 + cb + j] = (bf16)f2bf(o);
                }
            }
#undef LOADRAW
        } else {
            pg8::Gemm g{MIX, WPL}; pg8::StaticOrder S; S.init(M, 512, G - BATCH * NH, bx - BATCH * NH);
            pg8::EpiBf16S E{YRP, 1024, 512, ARG(23)};
            pg8::gemm_phase<pg8::EpiBf16S, true, true, 1, 256, 512, 256, 256>(L + RING_OFF, g, S, E);
        }
        if (BOTH(7)) GRID_BAR();
    }
    if (IN(8)) {
        pg8::Gemm g{YRP, WRP}; pg8::StaticOrder S; S.init(M, D, G, bx);
        pg8::EpiMerge E{MG, GATES};
        pg8::gemm_phase<pg8::EpiMerge, true, true, 2, 512, D, D, 0>(L + RING_OFF, g, S, E);
        if (BOTH(8)) GRID_BAR();
    }
    if (IN(9)) {
        pg8::Gemm g{MG, WO}; pg8::StaticOrder S; S.init(M, D, G, bx);
        pg8::EpiF32 E{MO, D};
        pg8::gemm_phase<pg8::EpiF32, true, true, 1, D, D, D, 0>(L + RING_OFF, g, S, E);
        if (BOTH(9)) GRID_BAR();
    }
    if (IN(10)) {
        for (int m = gw; m < M; m += NGW) res_norm_row(MO + (size_t)m * D, OUTP + (size_t)m * D, OUTP + (size_t)m * D, 1.0f, GAINS + 3 * D, HN + (size_t)m * D, GAINS + 4 * D, lane);
        if (BOTH(10)) GRID_BAR();
    }
    if (IN(11)) {
        pg8::Gemm g{HN, W2GU}; pg8::StaticOrder S; S.init(M, 2 * FF, G, bx);
        pg8::EpiSwiGLU E{ACT, FF};
        pg8::gemm_phase<pg8::EpiSwiGLU, true, true, 1, D, D, D, 0>(L + RING_OFF, g, S, E);
        if (BOTH(11)) GRID_BAR();
    }
    if (IN(12)) {
        pg8::Gemm g{ACT, W2D}; pg8::StaticOrder S; S.init(M, D, G, bx);
        pg8::EpiF32 E{Fb, D};
        pg8::gemm_phase<pg8::EpiF32, true, true, 1, FF, FF, FF, 0>(L + RING_OFF, g, S, E);
        if (N_LAUNCHES == 1) GRID_BAR();
    }
    if (IN(12) && N_LAUNCHES == 1) {
        for (int m = gw; m < M; m += NGW) res_norm_row(Fb + (size_t)m * D, OUTP + (size_t)m * D, OUTP + (size_t)m * D, 0.5f, GAINS + 5 * D, nullptr, nullptr, lane);
    }
#undef IN
#undef BOTH
#undef AP
#undef ARG
#undef WSB
#undef OUTP
#undef XIN
#undef GAINS
#undef ctl
#undef W1GU
#undef W1D
#undef WIN
#undef WLB
#undef WPL
#undef WRP
#undef WO
#undef W2GU
#undef W2D
#undef HN
#undef ACT
#undef Fb
#undef DW
#undef RKV
#undef POOL
#undef Gb
#undef GATES
#undef LOR
#undef YRP
#undef LIN
#undef MIX
#undef DA
#undef MG
#undef MO
}

__global__ void __launch_bounds__(512) final_res_kernel(Args args) {
    const int lane = threadIdx.x & 63, gw = blockIdx.x * 8 + (threadIdx.x >> 6), NGW = gridDim.x * 8;
    float* Fb = (float*)(args.ws + WS_F);
    for (int m = gw; m < M; m += NGW) res_norm_row(Fb + (size_t)m * D, args.out + (size_t)m * D, args.out + (size_t)m * D, 0.5f, args.in[1] + 5 * D, nullptr, nullptr, lane);
}

extern "C" void kernel_launch(void* const* d_in, const int* in_sizes, int n_in, void* d_out, int out_size, void* d_ws, size_t ws_size, hipStream_t stream) {
    static int grid = 0;
    if (grid == 0) {
        if (n_in != 30 || in_sizes[0] != M * D || out_size != M * D || ws_size < WS_END) { fprintf(stderr, "kernel_launch: unexpected shapes / workspace (n_in %d, in0 %d, out %d, ws %zu, need %zu)\n", n_in, n_in > 0 ? in_sizes[0] : -1, out_size, ws_size, (size_t)WS_END); grid = -1; return; }
        int dev = 0, cus = 0;
        if (hipGetDevice(&dev) != hipSuccess || hipDeviceGetAttribute(&cus, hipDeviceAttributeMultiprocessorCount, dev) != hipSuccess) { grid = -1; return; }
        if (hipFuncSetAttribute((const void*)fwd_kernel, hipFuncAttributeMaxDynamicSharedMemorySize, LDS_BYTES) != hipSuccess) { fprintf(stderr, "kernel_launch: hipFuncSetAttribute failed\n"); grid = -1; return; }
        (void)hipGetLastError();
        grid = cus;
    }
    if (grid < 0) return;
    if (hipMemsetAsync((char*)d_ws + WS_CTL, 0, CTL_ZERO_BYTES, stream) != hipSuccess) return;
    Args a{};
    for (int i = 0; i < 30; ++i) a.in[i] = (const float*)d_in[i];
    a.out = (float*)d_out; a.ws = (unsigned char*)d_ws;
    if (N_LAUNCHES == 1) {
        a.ph_lo = 0; a.ph_hi = NPHASE; a.li = 0;
        hipLaunchKernelGGL(fwd_kernel, dim3(grid), dim3(NWAVES * 64), LDS_BYTES, stream, a);
    } else {
        for (int li = 0; li < NPHASE; ++li) { a.ph_lo = li; a.ph_hi = li + 1; a.li = li; hipLaunchKernelGGL(fwd_kernel, dim3(grid), dim3(NWAVES * 64), LDS_BYTES, stream, a); }
        hipLaunchKernelGGL(final_res_kernel, dim3(grid), dim3(512), 0, stream, a);
    }
}
```
